# Optimizing an MI355X kernel written in HIP

```python
import math
import jax, jax.numpy as jnp
from jax import lax
import numpy as np

D_MODEL = 1024
BATCH = 8
SEQ = 2048
DEPTH = 1

D_MIX = D_MODEL
HG_WIDTH = D_MIX // 2
HG_HEAD_DIM = 128
HG_HEADS = HG_WIDTH // HG_HEAD_DIM
HG_CHUNK = 64
SW_WIDTH = D_MIX - HG_WIDTH
SW_HEAD_DIM = 64
SW_Q_HEADS = SW_WIDTH // SW_HEAD_DIM
SW_KV_HEADS = SW_Q_HEADS // 4
SW_KV_WIDTH = SW_KV_HEADS * SW_HEAD_DIM
WINDOW = 128
ROPE_THETA = 500000.0
ROPE_DIM = SW_HEAD_DIM // 4
DN_ALPHA = (2.0 * DEPTH) ** 0.25
DN_BETA = (8.0 * DEPTH) ** -0.25
LN_EPS = 1e-5
RMS_EPS = 1e-6
IN_SIZES = (HG_WIDTH, HG_WIDTH, HG_WIDTH, HG_WIDTH, SW_WIDTH, SW_KV_WIDTH, SW_KV_WIDTH, SW_WIDTH)
IN_WIDTH = sum(IN_SIZES)
IN_SPLITS = tuple(int(s) for s in np.cumsum(IN_SIZES)[:-1])

kernel_name = "hybrid_hgrn2_swa_sink_deepnorm"


def hgrn2_chunk(q, k, v, log_f):
    B, T, H, K = q.shape
    V = v.shape[-1]
    C = HG_CHUNK
    N = T // C
    q = q.reshape(B, N, C, H, K)
    k = k.reshape(B, N, C, H, K)
    v = v.reshape(B, N, C, H, V)
    log_f = log_f.reshape(B, N, C, H, K)
    G = jnp.cumsum(log_f, axis=2)
    G_last = G[:, :, -1]
    q_dec = q * jnp.exp(G)
    k_dec = k * jnp.exp(-G)
    causal = jnp.tril(jnp.ones((C, C), dtype=bool))
    A = jnp.einsum('bnthk,bnshk->bnhts', q_dec, k_dec)
    A = jnp.where(causal, A, 0.0)
    o_intra = jnp.einsum('bnhts,bnshv->bnthv', A, v)
    inc = jnp.einsum('bnshk,bnshv->bnhkv', k * jnp.exp(G_last[:, :, None] - G), v)
    decay = jnp.exp(G_last)

    def step(S, xs):
        d, u = xs
        return d[..., None] * S + u, S

    S0 = jnp.zeros((B, H, K, V), q.dtype)
    _, S_prev = lax.scan(step, S0, (jnp.moveaxis(decay, 1, 0), jnp.moveaxis(inc, 1, 0)))
    S_prev = jnp.moveaxis(S_prev, 0, 1)
    o_inter = jnp.einsum('bnthk,bnhkv->bnthv', q_dec, S_prev)
    return (o_intra + o_inter).reshape(B, T, H, V)


def partial_rope(x, cos, sin):
    half = ROPE_DIM // 2
    x1 = x[..., :half]
    x2 = x[..., half:ROPE_DIM]
    rot = jnp.concatenate([x1 * cos - x2 * sin, x2 * cos + x1 * sin], axis=-1)
    return jnp.concatenate([rot, x[..., ROPE_DIM:]], axis=-1)


def swa_with_sinks(q, k, v, sinks):
    B, T, Hq, D = q.shape
    Hkv = k.shape[2]
    G = Hq // Hkv
    W = WINDOW
    nb = T // W
    qb = q.reshape(B, nb, W, Hkv, G, D)
    pad = jnp.zeros((B, W, Hkv, D), k.dtype)
    kb = jnp.concatenate([pad, k], axis=1).reshape(B, nb + 1, W, Hkv, D)
    vb = jnp.concatenate([pad, v], axis=1).reshape(B, nb + 1, W, Hkv, D)
    kw = jnp.concatenate([kb[:, :-1], kb[:, 1:]], axis=2)
    vw = jnp.concatenate([vb[:, :-1], vb[:, 1:]], axis=2)
    s = jnp.einsum('bnqhgd,bnkhd->bnhgqk', qb, kw).astype(jnp.float32) * (D ** -0.5)
    t = jnp.arange(W)[:, None]
    j = jnp.arange(2 * W)[None, :]
    band = (j > t) & (j <= t + W)
    valid = (jnp.arange(nb)[:, None, None] > 0) | (j[None] >= W)
    mask = band[None] & valid
    s = jnp.where(mask[None, :, None, None], s, -jnp.inf)
    sink = sinks.astype(jnp.float32).reshape(1, 1, Hkv, G, 1, 1)
    m = jnp.maximum(jnp.max(s, axis=-1, keepdims=True), sink)
    p = jnp.exp(s - m)
    denom = jnp.sum(p, axis=-1, keepdims=True) + jnp.exp(sink - m)
    p = (p / denom).astype(v.dtype)
    o = jnp.einsum('bnhgqk,bnkhd->bnqhgd', p, vw)
    return o.reshape(B, T, Hq * D)


def setup_inputs(seed: int = 0) -> dict:
    key = jax.random.key(seed)
    ks = jax.random.split(key, 8)
    x = jax.random.normal(ks[0], (BATCH, SEQ, D_MODEL), jnp.float32)
    col_scale = jnp.concatenate([
        jnp.ones((HG_WIDTH,)), jnp.ones((HG_WIDTH,)), jnp.full((HG_WIDTH,), DN_BETA), jnp.ones((HG_WIDTH,)),
        jnp.ones((SW_WIDTH,)), jnp.ones((SW_KV_WIDTH,)), jnp.full((SW_KV_WIDTH,), DN_BETA), jnp.ones((SW_WIDTH,)),
    ]).astype(jnp.float32)
    w_in = jax.random.normal(ks[1], (DEPTH, D_MODEL, IN_WIDTH), jnp.float32) * (D_MODEL ** -0.5) * col_scale
    lb_logits = 0.1 * jax.random.normal(ks[2], (DEPTH + 1, HG_WIDTH), jnp.float32)
    hg_norm_w = 1.0 + 0.02 * jax.random.normal(ks[3], (DEPTH, HG_WIDTH), jnp.float32)
    sinks = 0.5 * jax.random.normal(ks[4], (DEPTH, SW_Q_HEADS), jnp.float32)
    w_out = jax.random.normal(ks[5], (DEPTH, D_MIX, D_MODEL), jnp.float32) * (D_MIX ** -0.5) * DN_BETA
    ln_g = 1.0 + 0.02 * jax.random.normal(ks[6], (DEPTH, D_MODEL), jnp.float32)
    ln_b = 0.02 * jax.random.normal(ks[7], (DEPTH, D_MODEL), jnp.float32)
    return {"x": x, "w_in": w_in, "lb_logits": lb_logits, "hg_norm_w": hg_norm_w,
            "sinks": sinks, "w_out": w_out, "ln_g": ln_g, "ln_b": ln_b}


def reference(x, w_in, lb_logits, hg_norm_w, sinks, w_out, ln_g, ln_b):
    B, T, _ = x.shape
    f32 = jnp.float32
    dt = x.dtype
    pos = jnp.arange(T, dtype=f32)
    inv_freq = ROPE_THETA ** (-jnp.arange(0, ROPE_DIM, 2, dtype=f32) / ROPE_DIM)
    ang = pos[:, None] * inv_freq[None, :]
    cos = jnp.cos(ang)[:, None, :].astype(dt)
    sin = jnp.sin(ang)[:, None, :].astype(dt)
    lower_bounds = jnp.cumsum(jax.nn.softmax(lb_logits.astype(f32), axis=0), axis=0)
    h_res = x
    for layer in range(DEPTH):
        h = jnp.einsum('btd,de->bte', h_res, w_in[layer])
        hq, hf, hi, hg, aq, ak, av, ag = jnp.split(h, IN_SPLITS, axis=-1)
        lb = lower_bounds[layer]
        f = lb + (1.0 - lb) * jax.nn.sigmoid(hf.astype(f32))
        log_f = jnp.log(f)
        k_in = 1.0 - f
        q_h = jax.nn.silu(hq.astype(f32))
        rs = lambda a: a.reshape(B, T, HG_HEADS, HG_HEAD_DIM)
        o_h = hgrn2_chunk(rs(q_h), rs(k_in), rs(hi.astype(f32)), rs(log_f))
        o_h = o_h * lax.rsqrt(jnp.mean(o_h * o_h, axis=-1, keepdims=True) + RMS_EPS)
        o_h = o_h * hg_norm_w[layer].astype(f32).reshape(HG_HEADS, HG_HEAD_DIM)
        o_h = o_h.reshape(B, T, HG_WIDTH).astype(dt) * jax.nn.silu(hg)
        q_a = partial_rope(aq.reshape(B, T, SW_Q_HEADS, SW_HEAD_DIM), cos, sin)
        k_a = partial_rope(ak.reshape(B, T, SW_KV_HEADS, SW_HEAD_DIM), cos, sin)
        v_a = av.reshape(B, T, SW_KV_HEADS, SW_HEAD_DIM)
        o_a = swa_with_sinks(q_a, k_a, v_a, sinks[layer]) * jax.nn.silu(ag)
        mix = jnp.concatenate([o_h, o_a], axis=-1)
        out = jnp.einsum('bte,ed->btd', mix, w_out[layer])
        z = DN_ALPHA * h_res.astype(f32) + out.astype(f32)
        mu = jnp.mean(z, axis=-1, keepdims=True)
        var = jnp.mean(jnp.square(z - mu), axis=-1, keepdims=True)
        z = (z - mu) * lax.rsqrt(var + LN_EPS)
        h_res = (z * ln_g[layer].astype(f32) + ln_b[layer].astype(f32)).astype(dt)
    return h_res
```

```cpp
#include <hip/hip_runtime.h>
#include <cstdint>
#include <cstdio>

constexpr int BATCH = 8, SEQ = 2048, DM = 1024, M = BATCH * SEQ;
constexpr int HGW = 512, HGH = 4, HGD = 128, CH = 64, NCH = SEQ / CH;
constexpr int SWW = 512, SWD = 64, SWQ = 8, SWKV = 2, KVW = SWKV * SWD, WIN = 128;
constexpr int INW = 3328;
constexpr float DN_ALPHA = 1.189207115002721f;
constexpr float LN_EPS = 1e-5f, RMS_EPS = 1e-6f;
constexpr float LOG2E = 1.4426950408889634f;
constexpr float QSCALE = 0.125f * LOG2E;

typedef unsigned short bf16;
__host__ __device__ __forceinline__ unsigned f2bf(float f) { unsigned u = __builtin_bit_cast(unsigned, f); return (u + 0x7fffu + ((u >> 16) & 1u)) >> 16; }
__host__ __device__ __forceinline__ float bf2f(unsigned h) { return __builtin_bit_cast(float, h << 16); }

constexpr size_t MiB = 1u << 20;
constexpr size_t WS_CTL  = 0;
constexpr size_t WS_ROPE = 1 * MiB;
constexpr size_t WS_WINT = 2 * MiB;
constexpr size_t WS_WOT  = 10 * MiB;
constexpr size_t WS_XB   = 12 * MiB;
constexpr size_t WS_QH   = 44 * MiB;
constexpr size_t WS_LF   = 60 * MiB;
constexpr size_t WS_VH   = 92 * MiB;
constexpr size_t WS_GH   = 108 * MiB;
constexpr size_t WS_QA   = 124 * MiB;
constexpr size_t WS_KA   = 140 * MiB;
constexpr size_t WS_VA   = 144 * MiB;
constexpr size_t WS_GA   = 148 * MiB;
constexpr size_t WS_SP   = 164 * MiB;
constexpr size_t WS_MIX  = 196 * MiB;
constexpr size_t WS_END  = 228 * MiB;

__host__ __device__ __forceinline__ int rope_pi(int s) { return (s >= 16) ? s : ((s & 3) | ((s & 4) << 1) | ((s & 8) >> 1)); }

__global__ void k_rope_table(float* cs) {
    const int i = blockIdx.x * blockDim.x + threadIdx.x; if (i >= SEQ * 8) return;
    const int t = i >> 3, f = i & 7;
    const float inv = powf(500000.0f, -(float)(2 * f) / 16.0f);
    const float ang = (float)t * inv;
    cs[i] = (float)cos((double)ang); cs[SEQ * 8 + i] = (float)sin((double)ang);
}

template <int MODE, typename TA>
__global__ void __launch_bounds__(256) k_naive_gemm(const TA* __restrict__ A, const float* __restrict__ B, int K, int N,
                                                    unsigned char* ws, const float* __restrict__ lb_logits, float* outp) {
    __shared__ float As[16][64 + 1], Bs[16][64 + 1], Cs[64][64 + 1];
    const int tx = threadIdx.x & 15, ty = threadIdx.x >> 4, m0 = blockIdx.y * 64, n0 = blockIdx.x * 64;
    float acc[4][4] = {};
    for (int k0 = 0; k0 < K; k0 += 16) {
        for (int i = threadIdx.x; i < 64 * 16; i += 256) { const int r = i >> 4, c = i & 15; float v;
            if constexpr (sizeof(TA) == 4) v = ((const float*)A)[(size_t)(m0 + r) * K + k0 + c]; else v = bf2f(((const bf16*)A)[(size_t)(m0 + r) * K + k0 + c]);
            As[c][r] = v; }
        for (int i = threadIdx.x; i < 16 * 64; i += 256) { const int r = i >> 6, c = i & 63; Bs[r][c] = B[(size_t)(k0 + r) * N + n0 + c]; }
        __syncthreads();
#pragma unroll
        for (int k = 0; k < 16; ++k) { float a[4], b[4];
#pragma unroll
            for (int i = 0; i < 4; ++i) { a[i] = As[k][ty * 4 + i]; b[i] = Bs[k][tx + 16 * i]; }
#pragma unroll
            for (int i = 0; i < 4; ++i)
#pragma unroll
                for (int j = 0; j < 4; ++j) acc[i][j] = fmaf(a[i], b[j], acc[i][j]); }
        __syncthreads();
    }
    if constexpr (MODE == 1) {
#pragma unroll
        for (int i = 0; i < 4; ++i)
#pragma unroll
            for (int j = 0; j < 4; ++j) outp[(size_t)(m0 + ty * 4 + i) * N + n0 + tx + 16 * j] = acc[i][j];
    } else {
#pragma unroll
        for (int i = 0; i < 4; ++i)
#pragma unroll
            for (int j = 0; j < 4; ++j) Cs[ty * 4 + i][tx + 16 * j] = acc[i][j];
        __syncthreads();
        const float* cs = (const float*)(ws + WS_ROPE);
        for (int e = threadIdx.x; e < 64 * 64; e += 256) {
            const int r = e >> 6, c = e & 63, m = m0 + r, col = n0 + c, t = m & (SEQ - 1);
            const float v = Cs[r][c];
            if (col < 512) { ((bf16*)(ws + WS_QH))[(size_t)m * 512 + col] = f2bf(v / (1.f + expf(-v))); }
            else if (col < 1024) { const int cc = col - 512; const float l0 = lb_logits[cc], l1 = lb_logits[512 + cc]; const float lb = 1.f / (1.f + expf(l1 - l0));
                const float f = lb + (1.f - lb) / (1.f + expf(-v)); ((float*)(ws + WS_LF))[(size_t)m * 512 + cc] = logf(f); }
            else if (col < 1536) { ((bf16*)(ws + WS_VH))[(size_t)m * 512 + col - 1024] = f2bf(v); }
            else if (col < 2048) { ((bf16*)(ws + WS_GH))[(size_t)m * 512 + col - 1536] = f2bf(v / (1.f + expf(-v))); }
            else if (col < 2688) {
                const int d = rope_pi(c); float o;
                if (d < 16) { const int fi = d & 7; const float co = cs[t * 8 + fi], si = cs[SEQ * 8 + t * 8 + fi];
                    const float x1 = Cs[r][d & 7], x2 = Cs[r][(d & 7) + 8]; o = (d < 8) ? (x1 * co - x2 * si) : (x2 * co + x1 * si); }
                else o = Cs[r][d];
                if (col < 2560) ((bf16*)(ws + WS_QA))[(size_t)m * 512 + (col - 2048)] = f2bf(o * QSCALE);
                else ((bf16*)(ws + WS_KA))[(size_t)m * 128 + (col - 2560)] = f2bf(o); }
            else if (col < 2816) { ((bf16*)(ws + WS_VA))[(size_t)m * 128 + col - 2688] = f2bf(v); }
            else { ((bf16*)(ws + WS_GA))[(size_t)m * 512 + col - 2816] = f2bf(v / (1.f + expf(-v))); }
        }
    }
}

__global__ void __launch_bounds__(128) k_naive_hgrn(const unsigned char* ws, float* OH) {
    __shared__ float red[2][8];
    const int vg = blockIdx.x & 15, h = (blockIdx.x >> 4) & 3, b = blockIdx.x >> 6, k = threadIdx.x, lane = k & 63, w = k >> 6;
    const bf16* QH = (const bf16*)(ws + WS_QH); const float* LF = (const float*)(ws + WS_LF); const bf16* VH = (const bf16*)(ws + WS_VH);
    float S[8] = {};
    for (int t = 0; t < SEQ; ++t) {
        const size_t m = (size_t)b * SEQ + t;
        const float f = expf(LF[m * 512 + h * 128 + k]), kk = 1.f - f, q = bf2f(QH[m * 512 + h * 128 + k]);
        float p[8];
#pragma unroll
        for (int i = 0; i < 8; ++i) { const float v = bf2f(VH[m * 512 + h * 128 + vg * 8 + i]); S[i] = f * S[i] + kk * v; p[i] = S[i] * q; }
#pragma unroll
        for (int i = 0; i < 8; ++i) {
#pragma unroll
            for (int o = 32; o >= 1; o >>= 1) p[i] += __shfl_xor(p[i], o); }
        if (lane == 0) {
#pragma unroll
            for (int i = 0; i < 8; ++i) red[w][i] = p[i]; }
        __syncthreads();
        if (k < 8) OH[m * 512 + h * 128 + vg * 8 + k] = red[0][k] + red[1][k];
        __syncthreads();
    }
}
__global__ void __launch_bounds__(256) k_naive_hgrn_norm(const unsigned char* ws_c, unsigned char* ws, const float* OH, const float* __restrict__ normw) {
    const int gw = (blockIdx.x * 256 + threadIdx.x) >> 6, lane = threadIdx.x & 63; if (gw >= M * HGH) return;
    const int m = gw >> 2, h = gw & 3;
    const float a = OH[(size_t)m * 512 + h * 128 + lane], c = OH[(size_t)m * 512 + h * 128 + 64 + lane];
    float s = a * a + c * c;
#pragma unroll
    for (int o = 32; o >= 1; o >>= 1) s += __shfl_xor(s, o);
    const float r = 1.0f / sqrtf(s * (1.f / 128.f) + RMS_EPS);
    const bf16* GH = (const bf16*)(ws_c + WS_GH); bf16* MIX = (bf16*)(ws + WS_MIX);
    MIX[(size_t)m * 1024 + h * 128 + lane] = f2bf(a * r * normw[h * 128 + lane] * bf2f(GH[(size_t)m * 512 + h * 128 + lane]));
    MIX[(size_t)m * 1024 + h * 128 + 64 + lane] = f2bf(c * r * normw[h * 128 + 64 + lane] * bf2f(GH[(size_t)m * 512 + h * 128 + 64 + lane]));
}
__global__ void __launch_bounds__(256) k_naive_swa(const unsigned char* ws_c, unsigned char* ws, const float* __restrict__ sinks) {
    const int gw = (blockIdx.x * 256 + threadIdx.x) >> 6, lane = threadIdx.x & 63; if (gw >= M * SWQ) return;
    const int m = gw >> 3, hq = gw & 7, kvh = hq >> 2, t = m & (SEQ - 1), b = m >> 11;
    const bf16* QA = (const bf16*)(ws_c + WS_QA); const bf16* KA = (const bf16*)(ws_c + WS_KA); const bf16* VA = (const bf16*)(ws_c + WS_VA); const bf16* GA = (const bf16*)(ws_c + WS_GA);
    float sc[2];
#pragma unroll
    for (int hh = 0; hh < 2; ++hh) { const int key = t - 127 + lane + 64 * hh; float s = -INFINITY;
        if (key >= 0) { s = 0.f; const size_t km = (size_t)b * SEQ + key;
            for (int d = 0; d < 64; ++d) s += bf2f(QA[(size_t)m * 512 + hq * 64 + d]) * bf2f(KA[km * 128 + kvh * 64 + d]); }
        sc[hh] = s; }
    const float sink = sinks[hq] * LOG2E;
    float mx = fmaxf(fmaxf(sc[0], sc[1]), sink);
#pragma unroll
    for (int o = 32; o >= 1; o >>= 1) mx = fmaxf(mx, __shfl_xor(mx, o));
    const float p0 = exp2f(sc[0] - mx), p1 = exp2f(sc[1] - mx);
    float den = p0 + p1;
#pragma unroll
    for (int o = 32; o >= 1; o >>= 1) den += __shfl_xor(den, o);
    den += exp2f(sink - mx);
    float o_ = 0.f;
    for (int j = 0; j < 128; ++j) { const float p = __shfl((j < 64) ? p0 : p1, j & 63); const int key = t - 127 + j;
        if (key >= 0) o_ += p * bf2f(VA[((size_t)b * SEQ + key) * 128 + kvh * 64 + lane]); }
    o_ = o_ / den * bf2f(GA[(size_t)m * 512 + hq * 64 + lane]);
    ((bf16*)(ws + WS_MIX))[(size_t)m * 1024 + 512 + hq * 64 + lane] = f2bf(o_);
}
__global__ void __launch_bounds__(256) k_naive_ln(const float* __restrict__ x, float* out, const float* __restrict__ g, const float* __restrict__ bta) {
    const int m = (blockIdx.x * 256 + threadIdx.x) >> 6, lane = threadIdx.x & 63; if (m >= M) return;
    float z[16]; float s = 0.f;
#pragma unroll
    for (int i = 0; i < 16; ++i) { const int c = lane + 64 * i; z[i] = DN_ALPHA * x[(size_t)m * DM + c] + out[(size_t)m * DM + c]; s += z[i]; }
#pragma unroll
    for (int o = 32; o >= 1; o >>= 1) s += __shfl_xor(s, o);
    const float mu = s * (1.f / DM); float q = 0.f;
#pragma unroll
    for (int i = 0; i < 16; ++i) { z[i] -= mu; q += z[i] * z[i]; }
#pragma unroll
    for (int o = 32; o >= 1; o >>= 1) q += __shfl_xor(q, o);
    const float r = 1.0f / sqrtf(q * (1.f / DM) + LN_EPS);
#pragma unroll
    for (int i = 0; i < 16; ++i) { const int c = lane + 64 * i; out[(size_t)m * DM + c] = z[i] * r * g[c] + bta[c]; }
}

extern "C" void kernel_launch(void* const* d_in, const int* in_sizes, int n_in, void* d_out, int out_size, void* d_ws, size_t ws_size, hipStream_t stream) {
    const float* x = (const float*)d_in[0]; const float* w_in = (const float*)d_in[1]; const float* lb_logits = (const float*)d_in[2]; const float* normw = (const float*)d_in[3];
    const float* sinks = (const float*)d_in[4]; const float* w_out = (const float*)d_in[5]; const float* ln_g = (const float*)d_in[6]; const float* ln_b = (const float*)d_in[7];
    unsigned char* ws = (unsigned char*)d_ws; float* out = (float*)d_out;
    if (ws_size < WS_END) { fprintf(stderr, "ws too small: %zu\n", ws_size); return; }
    float* OH = (float*)(ws + WS_XB);
    k_rope_table<<<(SEQ * 8 + 255) / 256, 256, 0, stream>>>((float*)(ws + WS_ROPE));
    k_naive_gemm<0, float><<<dim3(INW / 64, M / 64), 256, 0, stream>>>(x, w_in, DM, INW, ws, lb_logits, nullptr);
    k_naive_hgrn<<<BATCH * HGH * 16, 128, 0, stream>>>(ws, OH);
    k_naive_hgrn_norm<<<(M * HGH * 64) / 256, 256, 0, stream>>>(ws, ws, OH, normw);
    k_naive_swa<<<(M * SWQ * 64) / 256, 256, 0, stream>>>(ws, ws, sinks);
    k_naive_gemm<1, bf16><<<dim3(DM / 64, M / 64), 256, 0, stream>>>((const bf16*)(ws + WS_MIX), w_out, DM, DM, ws, nullptr, out);
    k_naive_ln<<<(M * 64) / 256, 256, 0, stream>>>(x, out, ln_g, ln_b);
}
```
